# Optimizing an MI355X kernel written in HIP

```python
import math
import jax, jax.numpy as jnp
from jax import lax
import numpy as np

D_MODEL = 1024
BATCH = 2
SEQ = 8192
DEPTH = 1

HEAD_DIM = 64
NSA_HEADS = 8
NSA_KV_GROUPS = 2
NSA_HPG = NSA_HEADS // NSA_KV_GROUPS
NSA_WIDTH = NSA_HEADS * HEAD_DIM
CMP_BLOCK = 32
CMP_STRIDE = 16
SLC_BLOCK = 64
SLC_TOPK = 16
WIN = 512
FORCE_SCORE = 1.0e4
DIL_HEADS = 8
DIL_WIDTH = DIL_HEADS * HEAD_DIM
DIL_PATTERNS = ((128, 1), (512, 4), (2048, 16))
Q_BLOCK = 128
RMS_EPS = 1e-6
N_ALIBI_HEADS = NSA_HEADS + DIL_HEADS
C_NSA_Q = NSA_WIDTH
C_NSA_KV = 6 * NSA_KV_GROUPS * HEAD_DIM
C_NSA_GATE = 3 * NSA_HEADS
C_NSA_Z = NSA_WIDTH
C_DIL_QKV = 3 * DIL_WIDTH
C_DIL_Z = DIL_WIDTH
C_MERGE = 2 * D_MODEL
C_IN = C_NSA_Q + C_NSA_KV + C_NSA_GATE + C_NSA_Z + C_DIL_QKV + C_DIL_Z + C_MERGE

kernel_name = 'nsa_dilated_hybrid_block'


def rmsnorm(x, g):
    xf = x.astype(jnp.float32)
    y = xf * lax.rsqrt(jnp.mean(xf * xf, axis=-1, keepdims=True) + RMS_EPS)
    return (y * g.astype(jnp.float32)).astype(x.dtype)


def masked_softmax(s, mask):
    s = jnp.where(mask, s, -jnp.inf)
    m = jnp.max(s, axis=-1, keepdims=True)
    m = jnp.where(jnp.isfinite(m), m, 0.0)
    e = jnp.exp(s - m)
    l = jnp.sum(e, axis=-1, keepdims=True)
    p = e / jnp.maximum(l, 1e-30)
    lse = m[..., 0] + jnp.log(l[..., 0])
    return p, lse


def alibi_slopes():
    s = 2.0 ** (-8.0 * np.arange(1, N_ALIBI_HEADS + 1) / N_ALIBI_HEADS)
    return jnp.asarray(s[0::2], jnp.float32), jnp.asarray(s[1::2], jnp.float32)


def overlap_matrix(n_cmp, n_sel):
    i = np.arange(n_cmp)[:, None]
    j = np.arange(n_sel)[None, :]
    lo = np.maximum(i * CMP_STRIDE, j * SLC_BLOCK)
    hi = np.minimum(i * CMP_STRIDE + CMP_BLOCK, (j + 1) * SLC_BLOCK)
    return (np.clip(hi - lo, 0, None) / CMP_BLOCK).astype(np.float32)


def nsa_compress(src, pos, w1, w2):
    S = src.shape[1]
    n_cmp = (S - CMP_BLOCK) // CMP_STRIDE + 1
    idx = np.arange(n_cmp)[:, None] * CMP_STRIDE + np.arange(CMP_BLOCK)[None, :]
    blocks = src[:, idx] + pos[None, None, :, None, :]
    hid = jax.nn.gelu(jnp.einsum('bnlgd,lde->bgne', blocks, w1))
    return jnp.einsum('bgne,ef->bgnf', hid, w2)


def nsa_attention(q, kv, gates, pos_k, w1_k, w2_k, pos_v, w1_v, w2_v, slopes):
    B, S, H, dh = q.shape
    G, hpg = NSA_KV_GROUPS, NSA_HPG
    qg = q.reshape(B, S, G, hpg, dh).transpose(0, 2, 3, 1, 4)
    k_cmp = nsa_compress(kv[:, :, 0], pos_k, w1_k, w2_k)
    v_cmp = nsa_compress(kv[:, :, 1], pos_v, w1_v, w2_v)
    n_cmp = k_cmp.shape[2]
    n_sel = S // SLC_BLOCK
    top_k = min(SLC_TOPK, n_sel)
    k_slc = kv[:, :, 2].transpose(0, 2, 1, 3).reshape(B, G, n_sel, SLC_BLOCK, dh)
    v_slc = kv[:, :, 3].transpose(0, 2, 1, 3).reshape(B, G, n_sel, SLC_BLOCK, dh)
    pad = ((0, 0), (0, 0), (WIN, 0), (0, 0))
    k_win = jnp.pad(kv[:, :, 4].transpose(0, 2, 1, 3), pad)
    v_win = jnp.pad(kv[:, :, 5].transpose(0, 2, 1, 3), pad)
    cmp_end = jnp.asarray(np.arange(n_cmp) * CMP_STRIDE + CMP_BLOCK - 1, jnp.int32)
    overlap = jnp.asarray(overlap_matrix(n_cmp, n_sel))
    slope = slopes.reshape(G, hpg)
    b_idx = jnp.arange(B)[:, None, None, None]
    g_idx = jnp.arange(G)[None, :, None, None]
    within = jnp.arange(SLC_BLOCK)
    win_off = jnp.arange(Q_BLOCK + WIN) - WIN
    blk_ids = jnp.arange(n_sel)

    def block(n):
        start = n * Q_BLOCK
        t = start + jnp.arange(Q_BLOCK)
        qb = lax.dynamic_slice_in_dim(qg, start, Q_BLOCK, axis=3)
        dist_c = t[:, None] - cmp_end[None, :]
        s_c = (jnp.einsum('bghqd,bgnd->bghqn', qb, k_cmp).astype(jnp.float32)
               - slope[None, :, :, None, None] * dist_c.astype(jnp.float32))
        p_c, _ = masked_softmax(s_c, dist_c >= 0)
        o_c = jnp.einsum('bghqn,bgnd->bghqd', p_c.astype(v_cmp.dtype), v_cmp)
        imp = jnp.einsum('bghqn,nj->bgqj', p_c, overlap)
        cur = t // SLC_BLOCK
        forced = (blk_ids[None] == 0) | (blk_ids[None] == cur[:, None]) | (blk_ids[None] == cur[:, None] - 1)
        valid = blk_ids[None] <= cur[:, None]
        score = jnp.where(valid, jnp.where(forced, FORCE_SCORE, imp), -1.0)
        top_val, top_idx = lax.top_k(score, top_k)
        kb = k_slc[b_idx, g_idx, top_idx]
        vb = v_slc[b_idx, g_idx, top_idx]
        pos_s = top_idx[..., None] * SLC_BLOCK + within
        dist_s = t[None, None, :, None, None] - pos_s
        mask_s = (top_val >= 0.0)[..., None] & (dist_s >= 0)
        s_s = (jnp.einsum('bghqd,bgqkld->bghqkl', qb, kb).astype(jnp.float32)
               - slope[None, :, :, None, None, None] * dist_s[:, :, None].astype(jnp.float32))
        shp = s_s.shape
        p_s, _ = masked_softmax(s_s.reshape(shp[:4] + (-1,)),
                                mask_s[:, :, None].reshape(B, G, 1, Q_BLOCK, -1))
        o_s = jnp.einsum('bghqkl,bgqkld->bghqd', p_s.reshape(shp).astype(vb.dtype), vb)
        kw = lax.dynamic_slice_in_dim(k_win, start, Q_BLOCK + WIN, axis=2)
        vw = lax.dynamic_slice_in_dim(v_win, start, Q_BLOCK + WIN, axis=2)
        pos_w = start + win_off
        dist_w = t[:, None] - pos_w[None, :]
        mask_w = (dist_w >= 0) & (dist_w < WIN) & (pos_w[None, :] >= 0)
        s_w = (jnp.einsum('bghqd,bgkd->bghqk', qb, kw).astype(jnp.float32)
               - slope[None, :, :, None, None] * dist_w.astype(jnp.float32))
        p_w, _ = masked_softmax(s_w, mask_w)
        o_w = jnp.einsum('bghqk,bgkd->bghqd', p_w.astype(vw.dtype), vw)
        return o_c, o_s, o_w

    o_c, o_s, o_w = lax.map(block, jnp.arange(S // Q_BLOCK))

    def to_seq(o):
        return o.transpose(1, 0, 4, 2, 3, 5).reshape(B, S, H, dh)

    return (gates[:, :, 0, :, None] * to_seq(o_c) + gates[:, :, 1, :, None] * to_seq(o_s)
            + gates[:, :, 2, :, None] * to_seq(o_w))


def dilated_branch(q, k, v, slopes, window, dilation):
    B, S, H, dh = q.shape
    L = S // dilation
    wd = window // dilation
    c = Q_BLOCK
    nbd = -(-L // c)
    Lp = nbd * c

    def phase(a):
        a = a.reshape(B, L, dilation, H, dh).transpose(0, 3, 2, 1, 4)
        return jnp.pad(a, ((0, 0), (0, 0), (0, 0), (c, Lp - L), (0, 0)))

    def band(a):
        prev = a[..., :Lp, :].reshape(B, H, dilation, nbd, c, dh)
        cur = a[..., c:, :].reshape(B, H, dilation, nbd, c, dh)
        return jnp.concatenate([prev, cur], axis=-2)

    qp = phase(q)[..., c:, :].reshape(B, H, dilation, nbd, c, dh)
    kb = band(phase(k))
    vb = band(phase(v))
    i = np.arange(c)[:, None]
    j = np.arange(2 * c)[None, :]
    kk = c + i - j
    key_l = (np.arange(nbd)[:, None, None] - 1) * c + j[None]
    mask = jnp.asarray((kk >= 0)[None] & (kk <= wd)[None] & (key_l >= 0))
    dist = jnp.asarray((kk * dilation).astype(np.float32))
    s = (jnp.einsum('bhpnqd,bhpnkd->bhpnqk', qp, kb).astype(jnp.float32)
         - slopes[None, :, None, None, None, None] * dist)
    p, lse = masked_softmax(s, mask[None, None, None])
    o = jnp.einsum('bhpnqk,bhpnkd->bhpnqd', p.astype(vb.dtype), vb)
    o = o.reshape(B, H, dilation, Lp, dh)[..., :L, :].transpose(0, 3, 2, 1, 4).reshape(B, S, H, dh)
    lse = lse.reshape(B, H, dilation, Lp)[..., :L].transpose(0, 3, 2, 1).reshape(B, S, H)
    return o, lse


def dilated_attention(q, k, v, slopes):
    outs, lses = [], []
    for window, dilation in DIL_PATTERNS:
        o, lse = dilated_branch(q, k, v, slopes, window, dilation)
        outs.append(o)
        lses.append(lse)
    w = jax.nn.softmax(jnp.stack(lses, axis=0), axis=0)
    return jnp.sum(w[..., None].astype(q.dtype) * jnp.stack(outs, axis=0), axis=0)


def hybrid_layer(xn, w_in, cmp_pos_k, cmp_w1_k, cmp_w2_k, cmp_pos_v, cmp_w1_v, cmp_w2_v,
                 w_br_nsa, w_br_dil, w_out):
    B, S, _ = xn.shape
    proj = jnp.einsum('bsd,dc->bsc', xn, w_in)
    offs = np.cumsum([C_NSA_Q, C_NSA_KV, C_NSA_GATE, C_NSA_Z, C_DIL_QKV, C_DIL_Z]).tolist()
    q_n, kv_n, g_n, z_n, qkv_d, z_d, mg = jnp.split(proj, offs, axis=-1)
    scale = HEAD_DIM ** -0.5
    slopes_nsa, slopes_dil = alibi_slopes()
    o_nsa = nsa_attention(q_n.reshape(B, S, NSA_HEADS, HEAD_DIM) * scale,
                          kv_n.reshape(B, S, 6, NSA_KV_GROUPS, HEAD_DIM),
                          jax.nn.sigmoid(g_n.reshape(B, S, 3, NSA_HEADS)),
                          cmp_pos_k, cmp_w1_k, cmp_w2_k, cmp_pos_v, cmp_w1_v, cmp_w2_v, slopes_nsa)
    o_nsa = o_nsa.reshape(B, S, NSA_WIDTH) * jax.nn.silu(z_n)
    qkv_d = qkv_d.reshape(B, S, 3, DIL_HEADS, HEAD_DIM)
    o_dil = dilated_attention(qkv_d[:, :, 0] * scale, qkv_d[:, :, 1], qkv_d[:, :, 2], slopes_dil)
    o_dil = o_dil.reshape(B, S, DIL_WIDTH) * jax.nn.silu(z_d)
    mg = jax.nn.sigmoid(mg.reshape(B, S, 2, D_MODEL))
    merged = (mg[:, :, 0] * jnp.einsum('bsc,cd->bsd', o_nsa, w_br_nsa)
              + mg[:, :, 1] * jnp.einsum('bsc,cd->bsd', o_dil, w_br_dil))
    return jnp.einsum('bsd,de->bse', merged, w_out)


def setup_inputs(seed: int = 0) -> dict:
    key = jax.random.key(seed)
    ks = jax.random.split(key, 13)
    hd = HEAD_DIM

    def nrm(k, shape, scale):
        return jax.random.normal(k, shape, jnp.float32) * scale

    return {
        'x': nrm(ks[0], (BATCH, SEQ, D_MODEL), 1.0),
        'norm_g': 1.0 + nrm(ks[1], (DEPTH, D_MODEL), 0.05),
        'w_in': nrm(ks[2], (DEPTH, D_MODEL, C_IN), D_MODEL ** -0.5),
        'cmp_pos_k': nrm(ks[3], (DEPTH, CMP_BLOCK, hd), 0.1),
        'cmp_w1_k': nrm(ks[4], (DEPTH, CMP_BLOCK, hd, hd), (CMP_BLOCK * hd) ** -0.5),
        'cmp_w2_k': nrm(ks[5], (DEPTH, hd, hd), hd ** -0.5),
        'cmp_pos_v': nrm(ks[6], (DEPTH, CMP_BLOCK, hd), 0.1),
        'cmp_w1_v': nrm(ks[7], (DEPTH, CMP_BLOCK, hd, hd), (CMP_BLOCK * hd) ** -0.5),
        'cmp_w2_v': nrm(ks[8], (DEPTH, hd, hd), hd ** -0.5),
        'w_br_nsa': nrm(ks[9], (DEPTH, NSA_WIDTH, D_MODEL), NSA_WIDTH ** -0.5),
        'w_br_dil': nrm(ks[10], (DEPTH, DIL_WIDTH, D_MODEL), DIL_WIDTH ** -0.5),
        'w_out': nrm(ks[11], (DEPTH, D_MODEL, D_MODEL), D_MODEL ** -0.5),
        'final_g': 1.0 + nrm(ks[12], (D_MODEL,), 0.05),
    }


def reference(x, norm_g, w_in, cmp_pos_k, cmp_w1_k, cmp_w2_k, cmp_pos_v, cmp_w1_v, cmp_w2_v,
              w_br_nsa, w_br_dil, w_out, final_g):
    h = x
    for layer in range(DEPTH):
        xn = rmsnorm(h, norm_g[layer])
        h = h + hybrid_layer(xn, w_in[layer], cmp_pos_k[layer], cmp_w1_k[layer], cmp_w2_k[layer],
                             cmp_pos_v[layer], cmp_w1_v[layer], cmp_w2_v[layer],
                             w_br_nsa[layer], w_br_dil[layer], w_out[layer])
    return rmsnorm(h, final_g)
```

```cpp
#include <hip/hip_runtime.h>
#include <cstdio>
#include <cstdint>

typedef unsigned short bf16_t;
typedef short bf16x8 __attribute__((ext_vector_type(8)));
typedef float f32x4 __attribute__((ext_vector_type(4)));
typedef float f32x16 __attribute__((ext_vector_type(16)));
typedef unsigned u32x4 __attribute__((ext_vector_type(4)));
typedef unsigned u32x2 __attribute__((ext_vector_type(2)));

constexpr int NB = 2, S = 8192, M = NB * S, DM = 1024, CIN = 5912, NC = 6144;
constexpr int NCMP = 511, NSEL = 128;
constexpr float LOG2E = 1.4426950408889634f, C2 = 0.125f * LOG2E, RMS_EPS = 1e-6f;
constexpr int C_QN = 0, C_KV = 512, C_ZN = 1280, C_QKVD = 1792, C_ZD = 3328, C_MG = 3840, C_GATE = 5888, C_END = 5912;
constexpr int S_QN = 0, S_KV = 512, S_GATE = 1280, S_ZN = 1304, S_QKVD = 1816, S_ZD = 3352, S_MG = 3864;

constexpr size_t MiB = 1u << 20;
constexpr size_t WS_CTL = 0;
constexpr size_t WS_WTIN = 1 * MiB;
constexpr size_t WS_WTBR = 13 * MiB;
constexpr size_t WS_WTOUT = 15 * MiB;
constexpr size_t WS_W1T = 17 * MiB;
constexpr size_t WS_W2T = WS_W1T + 512 * 1024;
constexpr size_t WS_CBIAS = WS_W2T + 16 * 1024;
constexpr size_t WS_KCMP = 23 * MiB;
constexpr size_t WS_GATE = 18 * MiB;
constexpr size_t WS_LSE = 20 * MiB;
constexpr size_t WS_SEL = 22 * MiB;
constexpr size_t WS_XN = 24 * MiB;
constexpr size_t WS_OW = 24 * MiB;
constexpr size_t WS_OD0 = 40 * MiB;
constexpr size_t WS_QN = 56 * MiB;
constexpr size_t WS_KV6 = 72 * MiB;
constexpr size_t WS_ZN = 98 * MiB;
constexpr size_t WS_ZD = 114 * MiB;
constexpr size_t WS_QKVD = 130 * MiB;
constexpr size_t WS_ACAT = 130 * MiB;
constexpr size_t WS_OD12 = 178 * MiB;
constexpr size_t WS_MERGED = 178 * MiB;
constexpr size_t WS_OC = 210 * MiB;
constexpr size_t WS_T1S = 24 * MiB;
constexpr size_t WS_END = 256 * MiB;

struct Ptrs {
    const float* x; const float* norm_g; const float* w_in; const float* pos_k; const float* w1_k; const float* w2_k;
    const float* pos_v; const float* w1_v; const float* w2_v; const float* w_brn; const float* w_brd; const float* w_out; const float* final_g;
    float* out; unsigned char* ws;
};

__device__ __forceinline__ unsigned f2bf(float f) { unsigned u = __builtin_bit_cast(unsigned, f); return (u + 0x7fffu + ((u >> 16) & 1u)) >> 16; }
__device__ __forceinline__ unsigned pk2(float lo, float hi) { return f2bf(lo) | (f2bf(hi) << 16); }
__device__ __forceinline__ float bf2f(unsigned short b) { return __builtin_bit_cast(float, (unsigned)b << 16); }
__device__ __forceinline__ float bflo(unsigned w) { return __builtin_bit_cast(float, w << 16); }
__device__ __forceinline__ float bfhi(unsigned w) { return __builtin_bit_cast(float, w & 0xffff0000u); }
__device__ __forceinline__ float sigmoidf_(float v) { return 1.0f / (1.0f + __expf(-v)); }
__device__ __forceinline__ float siluf_(float v) { return v / (1.0f + __expf(-v)); }
__device__ __forceinline__ float gelu_tanh(float v) { const float u = 0.7978845608028654f * (v + 0.044715f * v * v * v); return 0.5f * v * (1.0f + tanhf(u)); }
__device__ __forceinline__ float wave_sum(float v) {
#pragma unroll
    for (int o = 1; o < 64; o <<= 1) v += __shfl_xor(v, o);
    return v;
}
__device__ __forceinline__ float nsa_slope2(int h) { return exp2f(-0.5f * (float)(2 * h + 1)) * LOG2E; }
__device__ __forceinline__ float dil_slope2(int h) { return exp2f(-(float)(h + 1)) * LOG2E; }
__device__ __forceinline__ void load_row64(const bf16_t* p, float (&v)[64]) {
    const u32x4* q = (const u32x4*)p;
#pragma unroll
    for (int i = 0; i < 8; ++i) { const u32x4 w = q[i];
        v[8 * i + 0] = bflo(w.x); v[8 * i + 1] = bfhi(w.x); v[8 * i + 2] = bflo(w.y); v[8 * i + 3] = bfhi(w.y);
        v[8 * i + 4] = bflo(w.z); v[8 * i + 5] = bfhi(w.z); v[8 * i + 6] = bflo(w.w); v[8 * i + 7] = bfhi(w.w); }
}
__device__ __forceinline__ float dot_row64(const bf16_t* p, const float (&q)[64]) {
    const u32x4* kp = (const u32x4*)p; float s0 = 0.f, s1 = 0.f;
#pragma unroll
    for (int i = 0; i < 8; ++i) { const u32x4 w = kp[i];
        s0 += q[8 * i + 0] * bflo(w.x); s1 += q[8 * i + 1] * bfhi(w.x); s0 += q[8 * i + 2] * bflo(w.y); s1 += q[8 * i + 3] * bfhi(w.y);
        s0 += q[8 * i + 4] * bflo(w.z); s1 += q[8 * i + 5] * bfhi(w.z); s0 += q[8 * i + 6] * bflo(w.w); s1 += q[8 * i + 7] * bfhi(w.w); }
    return s0 + s1;
}
__device__ __forceinline__ void axpy_row64(const bf16_t* p, float a, float (&o)[64]) {
    const u32x4* vp = (const u32x4*)p;
#pragma unroll
    for (int i = 0; i < 8; ++i) { const u32x4 w = vp[i];
        o[8 * i + 0] += a * bflo(w.x); o[8 * i + 1] += a * bfhi(w.x); o[8 * i + 2] += a * bflo(w.y); o[8 * i + 3] += a * bfhi(w.y);
        o[8 * i + 4] += a * bflo(w.z); o[8 * i + 5] += a * bfhi(w.z); o[8 * i + 6] += a * bflo(w.w); o[8 * i + 7] += a * bfhi(w.w); }
}
__device__ __forceinline__ void store_row64_bf16(bf16_t* p, const float (&o)[64], float sc) {
    u32x4* q = (u32x4*)p;
#pragma unroll
    for (int i = 0; i < 8; ++i) { u32x4 w; w.x = pk2(o[8 * i] * sc, o[8 * i + 1] * sc); w.y = pk2(o[8 * i + 2] * sc, o[8 * i + 3] * sc);
        w.z = pk2(o[8 * i + 4] * sc, o[8 * i + 5] * sc); w.w = pk2(o[8 * i + 6] * sc, o[8 * i + 7] * sc); q[i] = w; }
}

__device__ __forceinline__ int win_src_col(int n) {
    if (n < C_ZN) return n;
    if (n < C_QKVD) return n - C_ZN + S_ZN;
    if (n < C_ZD) return n - C_QKVD + S_QKVD;
    if (n < C_MG) return n - C_ZD + S_ZD;
    if (n < C_GATE) return n - C_MG + S_MG;
    if (n < C_END) return n - C_GATE + S_GATE;
    return -1;
}
template <bool MAPW>
__device__ __forceinline__ void transpose_item(const float* W, int K, int ldw, bf16_t* WT, int item, int nblk, float* scr, int lane) {
    const int kb = item / nblk, nb = item % nblk, k0 = 64 * kb, n0 = 32 * nb;
    const int nd = n0 + (lane & 31); const int ns = MAPW ? win_src_col(nd) : nd;
#pragma unroll 8
    for (int i = 0; i < 32; ++i) { const int kk = 2 * i + (lane >> 5); scr[kk * 33 + (lane & 31)] = ns >= 0 ? W[(size_t)(k0 + kk) * ldw + ns] : 0.f; }
    __builtin_amdgcn_s_waitcnt(0xc07f); asm volatile("" ::: "memory");
    const int c = lane & 7;
#pragma unroll
    for (int j = 0; j < 4; ++j) { const int n = (lane >> 3) + 8 * j; const float* s = scr + (8 * c) * 33 + n;
        u32x4 o; o.x = pk2(s[0 * 33], s[1 * 33]); o.y = pk2(s[2 * 33], s[3 * 33]); o.z = pk2(s[4 * 33], s[5 * 33]); o.w = pk2(s[6 * 33], s[7 * 33]);
        *(u32x4*)(WT + (size_t)(n0 + n) * K + k0 + 8 * c) = o; }
    __builtin_amdgcn_s_waitcnt(0xc07f); asm volatile("" ::: "memory");
}
constexpr int IT_WIN = (DM / 64) * (NC / 32), IT_BR = (512 / 64) * (1024 / 32), IT_OUT = (1024 / 64) * (1024 / 32), IT_W1 = (2048 / 64) * 2, IT_W2 = 2;
constexpr int IT_TOTAL = IT_WIN + 2 * IT_BR + IT_OUT + 2 * IT_W1 + 2 * IT_W2;
__device__ __forceinline__ void prep_items(const Ptrs& P, float* scr, int gw, int ngw, int lane) {
    unsigned char* ws = P.ws;
    for (int it = gw; it < IT_TOTAL; it += ngw) {
        int r = it;
        if (r < IT_WIN) { transpose_item<true>(P.w_in, DM, CIN, (bf16_t*)(ws + WS_WTIN), r, NC / 32, scr, lane); continue; } r -= IT_WIN;
        if (r < IT_BR) { transpose_item<false>(P.w_brn, 512, 1024, (bf16_t*)(ws + WS_WTBR), r, 32, scr, lane); continue; } r -= IT_BR;
        if (r < IT_BR) { transpose_item<false>(P.w_brd, 512, 1024, (bf16_t*)(ws + WS_WTBR) + 1024 * 512, r, 32, scr, lane); continue; } r -= IT_BR;
        if (r < IT_OUT) { transpose_item<false>(P.w_out, 1024, 1024, (bf16_t*)(ws + WS_WTOUT), r, 32, scr, lane); continue; } r -= IT_OUT;
        if (r < IT_W1) { transpose_item<false>(P.w1_k, 2048, 64, (bf16_t*)(ws + WS_W1T), r, 2, scr, lane); continue; } r -= IT_W1;
        if (r < IT_W1) { transpose_item<false>(P.w1_v, 2048, 64, (bf16_t*)(ws + WS_W1T) + 64 * 2048, r, 2, scr, lane); continue; } r -= IT_W1;
        if (r < IT_W2) { transpose_item<false>(P.w2_k, 64, 64, (bf16_t*)(ws + WS_W2T), r, 2, scr, lane); continue; } r -= IT_W2;
        transpose_item<false>(P.w2_v, 64, 64, (bf16_t*)(ws + WS_W2T) + 64 * 64, r, 2, scr, lane);
    }
    for (int it = gw; it < 128; it += ngw) {
        const int kv = it >> 6, e = it & 63; const float* pos = kv ? P.pos_v : P.pos_k; const float* w1 = kv ? P.w1_v : P.w1_k;
        float s = 0.f;
        for (int k = lane; k < 2048; k += 64) s += pos[k] * w1[(size_t)k * 64 + e];
        s = wave_sum(s);
        if (lane == 0) ((float*)(ws + WS_CBIAS))[it] = s;
    }
    bf16_t* XN = (bf16_t*)(ws + WS_XN);
    for (int m = gw; m < M; m += ngw) {
        const f32x4* xr = (const f32x4*)(P.x + (size_t)m * DM) + lane; const f32x4* gr = (const f32x4*)P.norm_g + lane;
        f32x4 v[4]; float ss = 0.f;
#pragma unroll
        for (int j = 0; j < 4; ++j) { v[j] = xr[64 * j]; ss += (v[j].x * v[j].x + v[j].y * v[j].y) + (v[j].z * v[j].z + v[j].w * v[j].w); }
        const float rs = 1.0f / sqrtf(wave_sum(ss) * (1.f / DM) + RMS_EPS);
        unsigned long long* o8 = (unsigned long long*)(XN + (size_t)m * DM) + lane;
#pragma unroll
        for (int j = 0; j < 4; ++j) { const f32x4 g = gr[64 * j];
            o8[64 * j] = (unsigned long long)pk2(v[j].x * rs * g.x, v[j].y * rs * g.y) | ((unsigned long long)pk2(v[j].z * rs * g.z, v[j].w * rs * g.w) << 32); }
    }
}
__global__ void __launch_bounds__(256) k_prep(Ptrs P) {
    __shared__ float scr_all[4][64 * 33];
    const int lane = threadIdx.x & 63, wave = threadIdx.x >> 6;
    prep_items(P, scr_all[wave], blockIdx.x * 4 + wave, gridDim.x * 4, lane);
}

struct EpiInProj {
    unsigned char* ws; bf16_t* MG;
    __device__ __forceinline__ void store4(int row, int c, float v0, float v1, float v2, float v3) const {
        const int b = row >> 13, s = row & (S - 1);
        if (c < C_KV) { const int h = c >> 6, d = c & 63;
            *(u32x2*)((bf16_t*)(ws + WS_QN) + ((size_t)(b * 8 + h) * S + s) * 64 + d) = (u32x2){pk2(v0 * C2, v1 * C2), pk2(v2 * C2, v3 * C2)};
        } else if (c < C_ZN) { const int cc = c - C_KV, j = cc >> 7, g = (cc >> 6) & 1, d = cc & 63;
            *(u32x2*)((bf16_t*)(ws + WS_KV6) + ((size_t)((j * 2 + b) * 2 + g) * S + s) * 64 + d) = (u32x2){pk2(v0, v1), pk2(v2, v3)};
        } else if (c < C_QKVD) {
            *(u32x2*)((bf16_t*)(ws + WS_ZN) + (size_t)row * 512 + (c - C_ZN)) = (u32x2){pk2(siluf_(v0), siluf_(v1)), pk2(siluf_(v2), siluf_(v3))};
        } else if (c < C_ZD) { const int cc = c - C_QKVD, w = cc >> 9, h = (cc >> 6) & 7, d = cc & 63; const float sc = (w == 0) ? C2 : 1.0f;
            *(u32x2*)((bf16_t*)(ws + WS_QKVD) + ((size_t)((w * 2 + b) * 8 + h) * S + s) * 64 + d) = (u32x2){pk2(v0 * sc, v1 * sc), pk2(v2 * sc, v3 * sc)};
        } else if (c < C_MG) {
            *(u32x2*)((bf16_t*)(ws + WS_ZD) + (size_t)row * 512 + (c - C_ZD)) = (u32x2){pk2(siluf_(v0), siluf_(v1)), pk2(siluf_(v2), siluf_(v3))};
        } else if (c < C_GATE) {
            *(u32x2*)(MG + (size_t)row * 2048 + (c - C_MG)) = (u32x2){pk2(sigmoidf_(v0), sigmoidf_(v1)), pk2(sigmoidf_(v2), sigmoidf_(v3))};
        } else if (c < C_END) {
            *(f32x4*)((float*)(ws + WS_GATE) + (size_t)row * 24 + (c - C_GATE)) = (f32x4){sigmoidf_(v0), sigmoidf_(v1), sigmoidf_(v2), sigmoidf_(v3)};
        }
    }
};
struct EpiBranch {
    const bf16_t* MG; float* T1S; bf16_t* MERGED; int which, pad;
    __device__ __forceinline__ void store4(int row, int c, float v0, float v1, float v2, float v3) const {
        const u32x2 g = *(const u32x2*)(MG + (size_t)row * 2048 + which * 1024 + c);
        float* t = T1S + (size_t)row * 1024 + c;
        if (which == 0) { *(f32x4*)t = (f32x4){bflo(g.x) * v0, bfhi(g.x) * v1, bflo(g.y) * v2, bfhi(g.y) * v3}; }
        else { const f32x4 p = *(const f32x4*)t;
            *(u32x2*)(MERGED + (size_t)row * 1024 + c) = (u32x2){pk2(p.x + bflo(g.x) * v0, p.y + bfhi(g.x) * v1), pk2(p.z + bflo(g.y) * v2, p.w + bfhi(g.y) * v3)}; }
    }
};
struct EpiResid {
    const float* x; float* out;
    __device__ __forceinline__ void store4(int row, int c, float v0, float v1, float v2, float v3) const {
        const f32x4 xv = *(const f32x4*)(x + (size_t)row * DM + c);
        *(f32x4*)(out + (size_t)row * DM + c) = (f32x4){xv.x + v0, xv.y + v1, xv.z + v2, xv.w + v3};
    }
};

template <class Epi>
__global__ void __launch_bounds__(256) k_gemm_simple(const bf16_t* A, const bf16_t* Bt, int K, int n_tiles, Epi E) {
    const int lane = threadIdx.x & 63, wave = threadIdx.x >> 6, r32 = lane & 31, hi = lane >> 5;
    const int tn = blockIdx.x % n_tiles, tm = blockIdx.x / n_tiles;
    const int m = tm * 128 + wave * 32 + r32, n0 = tn * 64;
    const bf16_t* ap = A + (size_t)m * K + 8 * hi;
    const bf16_t* bp0 = Bt + (size_t)(n0 + r32) * K + 8 * hi; const bf16_t* bp1 = bp0 + (size_t)32 * K;
    f32x16 acc0 = {}, acc1 = {};
    for (int k = 0; k < K; k += 16) {
        const bf16x8 a = *(const bf16x8*)(ap + k), b0 = *(const bf16x8*)(bp0 + k), b1 = *(const bf16x8*)(bp1 + k);
        acc0 = __builtin_amdgcn_mfma_f32_32x32x16_bf16(b0, a, acc0, 0, 0, 0);
        acc1 = __builtin_amdgcn_mfma_f32_32x32x16_bf16(b1, a, acc1, 0, 0, 0);
    }
#pragma unroll
    for (int rg = 0; rg < 4; ++rg) {
        E.store4(m, n0 + 8 * rg + 4 * hi, acc0[4 * rg], acc0[4 * rg + 1], acc0[4 * rg + 2], acc0[4 * rg + 3]);
        E.store4(m, n0 + 32 + 8 * rg + 4 * hi, acc1[4 * rg], acc1[4 * rg + 1], acc1[4 * rg + 2], acc1[4 * rg + 3]);
    }
}

__global__ void __launch_bounds__(64) k_compress_naive(Ptrs P) {
    __shared__ float hid[64];
    const int i = blockIdx.x & 511, p = blockIdx.x >> 9;
    const int e = threadIdx.x, kv = p >> 2;
    bf16_t* outp = (bf16_t*)(P.ws + WS_KCMP) + ((size_t)p * 512 + i) * 64;
    if (i >= NCMP) { outp[e] = 0; return; }
    const bf16_t* src = (const bf16_t*)(P.ws + WS_KV6) + ((size_t)p * S + 16 * i) * 64;
    const bf16_t* w1 = (const bf16_t*)(P.ws + WS_W1T) + ((size_t)kv * 64 + e) * 2048;
    float s = ((const float*)(P.ws + WS_CBIAS))[kv * 64 + e];
    for (int k = 0; k < 2048; k += 8) { const u32x4 a = *(const u32x4*)(src + k), w = *(const u32x4*)(w1 + k);
        s += bflo(a.x) * bflo(w.x) + bfhi(a.x) * bfhi(w.x) + bflo(a.y) * bflo(w.y) + bfhi(a.y) * bfhi(w.y)
           + bflo(a.z) * bflo(w.z) + bfhi(a.z) * bfhi(w.z) + bflo(a.w) * bflo(w.w) + bfhi(a.w) * bfhi(w.w); }
    hid[e] = bf2f((unsigned short)f2bf(gelu_tanh(s)));
    __syncthreads();
    const bf16_t* w2 = (const bf16_t*)(P.ws + WS_W2T) + ((size_t)kv * 64 + e) * 64;
    float o = 0.f;
    for (int k = 0; k < 64; ++k) o += hid[k] * bf2f(w2[k]);
    outp[e] = (bf16_t)f2bf(o);
}

struct Soft { float m, l; };
#define ONLINE_STEP(sc, vrow) do { const float s_ = (sc); if (s_ > st.m) { const float f_ = exp2f(st.m - s_); st.l *= f_; _Pragma("unroll") for (int d_ = 0; d_ < 64; ++d_) o[d_] *= f_; st.m = s_; } \
    const float p_ = exp2f(s_ - st.m); st.l += p_; axpy_row64((vrow), p_, o); } while (0)

__global__ void __launch_bounds__(64) k_win_naive(Ptrs P) {
    const int t = blockIdx.x * 64 + threadIdx.x, h = blockIdx.y, b = blockIdx.z, g = h >> 2;
    const bf16_t* Kp = (const bf16_t*)(P.ws + WS_KV6) + (size_t)((4 * 2 + b) * 2 + g) * S * 64;
    const bf16_t* Vp = (const bf16_t*)(P.ws + WS_KV6) + (size_t)((5 * 2 + b) * 2 + g) * S * 64;
    float q[64], o[64]; load_row64((const bf16_t*)(P.ws + WS_QN) + ((size_t)(b * 8 + h) * S + t) * 64, q);
#pragma unroll
    for (int d = 0; d < 64; ++d) o[d] = 0.f;
    Soft st{-1e30f, 0.f}; const float sl = nsa_slope2(h);
    const int lo = t - 511 > 0 ? t - 511 : 0;
    for (int pos = t; pos >= lo; --pos) ONLINE_STEP(dot_row64(Kp + (size_t)pos * 64, q) - sl * (float)(t - pos), Vp + (size_t)pos * 64);
    store_row64_bf16((bf16_t*)(P.ws + WS_OW) + (size_t)(b * S + t) * 512 + h * 64, o, 1.0f / st.l);
}
__global__ void __launch_bounds__(64) k_dil_naive(Ptrs P) {
    const int t = blockIdx.x * 64 + threadIdx.x, h = blockIdx.y & 7, pat = blockIdx.y >> 3, b = blockIdx.z;
    const int dil = pat == 0 ? 1 : (pat == 1 ? 4 : 16);
    const bf16_t* Kp = (const bf16_t*)(P.ws + WS_QKVD) + (size_t)((1 * 2 + b) * 8 + h) * S * 64;
    const bf16_t* Vp = (const bf16_t*)(P.ws + WS_QKVD) + (size_t)((2 * 2 + b) * 8 + h) * S * 64;
    float q[64], o[64]; load_row64((const bf16_t*)(P.ws + WS_QKVD) + ((size_t)(b * 8 + h) * S + t) * 64, q);
#pragma unroll
    for (int d = 0; d < 64; ++d) o[d] = 0.f;
    Soft st{-1e30f, 0.f}; const float sl = dil_slope2(h);
    for (int n = 0; n <= 128; ++n) { const int pos = t - n * dil; if (pos < 0) break;
        ONLINE_STEP(dot_row64(Kp + (size_t)pos * 64, q) - sl * (float)(n * dil), Vp + (size_t)pos * 64); }
    bf16_t* od = (pat == 0) ? (bf16_t*)(P.ws + WS_OD0) : (bf16_t*)(P.ws + WS_OD12) + (size_t)(pat - 1) * M * 512;
    store_row64_bf16(od + (size_t)(b * S + t) * 512 + h * 64, o, 1.0f / st.l);
    ((float*)(P.ws + WS_LSE))[((size_t)pat * M + b * S + t) * 8 + h] = st.m + log2f(st.l);
}
__global__ void __launch_bounds__(256) k_dil_combine(Ptrs P) {
    const int idx = blockIdx.x * 256 + threadIdx.x; const int row = idx >> 6, c8 = idx & 63, h = c8 >> 3;
    const float* L = (const float*)(P.ws + WS_LSE);
    const float l0 = L[((size_t)0 * M + row) * 8 + h], l1 = L[((size_t)1 * M + row) * 8 + h], l2 = L[((size_t)2 * M + row) * 8 + h];
    const float mx = fmaxf(l0, fmaxf(l1, l2)); float w0 = exp2f(l0 - mx), w1 = exp2f(l1 - mx), w2 = exp2f(l2 - mx); const float inv = 1.0f / (w0 + w1 + w2);
    w0 *= inv; w1 *= inv; w2 *= inv;
    const size_t off = (size_t)row * 512 + c8 * 8;
    const u32x4 a = *(const u32x4*)((const bf16_t*)(P.ws + WS_OD0) + off), bb = *(const u32x4*)((const bf16_t*)(P.ws + WS_OD12) + off),
                c = *(const u32x4*)((const bf16_t*)(P.ws + WS_OD12) + (size_t)M * 512 + off), z = *(const u32x4*)((const bf16_t*)(P.ws + WS_ZD) + off);
    u32x4 o;
#define CMB(f) o.f = pk2((w0 * bflo(a.f) + w1 * bflo(bb.f) + w2 * bflo(c.f)) * bflo(z.f), (w0 * bfhi(a.f) + w1 * bfhi(bb.f) + w2 * bfhi(c.f)) * bfhi(z.f))
    CMB(x); CMB(y); CMB(z); CMB(w);
#undef CMB
    *(u32x4*)((bf16_t*)(P.ws + WS_ACAT) + (size_t)M * 512 + off) = o;
}
__global__ void __launch_bounds__(64) k_cmp_naive(Ptrs P) {
    __shared__ float imp[129 * 64];
    const int tid = threadIdx.x, t = blockIdx.x * 64 + tid, g = blockIdx.y, b = blockIdx.z;
    for (int j = 0; j < 129; ++j) imp[j * 64 + tid] = 0.f;
    const bf16_t* Kc = (const bf16_t*)(P.ws + WS_KCMP) + (size_t)((0 * 2 + b) * 2 + g) * 512 * 64;
    const bf16_t* Vc = (const bf16_t*)(P.ws + WS_KCMP) + (size_t)((1 * 2 + b) * 2 + g) * 512 * 64;
    int nv = t >= 31 ? (t - 31) / 16 + 1 : 0; if (nv > NCMP) nv = NCMP;
    for (int hh = 0; hh < 4; ++hh) {
        const int h = 4 * g + hh; const float sl = nsa_slope2(h);
        float q[64], o[64]; load_row64((const bf16_t*)(P.ws + WS_QN) + ((size_t)(b * 8 + h) * S + t) * 64, q);
#pragma unroll
        for (int d = 0; d < 64; ++d) o[d] = 0.f;
        float m = -1e30f, l = 0.f;
        for (int n = 0; n < nv; ++n) { const float s = dot_row64(Kc + (size_t)n * 64, q) - sl * (float)(t - (16 * n + 31));
            if (s > m) { l *= exp2f(m - s); m = s; } l += exp2f(s - m); }
        const float inv = l > 0.f ? 1.0f / l : 0.f;
        for (int n = 0; n < nv; ++n) { const float s = dot_row64(Kc + (size_t)n * 64, q) - sl * (float)(t - (16 * n + 31));
            const float p = exp2f(s - m) * inv; axpy_row64(Vc + (size_t)n * 64, p, o);
            const int J = n >> 2, r = n & 3;
            if (r == 3) { imp[J * 64 + tid] += 0.5f * p; imp[(J + 1) * 64 + tid] += 0.5f * p; } else imp[J * 64 + tid] += p; }
        float* oc = (float*)(P.ws + WS_OC) + (size_t)(b * S + t) * 512 + h * 64;
#pragma unroll
        for (int d = 0; d < 64; d += 4) *(f32x4*)(oc + d) = (f32x4){o[d], o[d + 1], o[d + 2], o[d + 3]};
    }
    const int cur = t >> 6;
    unsigned m0 = 1u, m1 = 0u, m2 = 0u, m3 = 0u; int nsel = 1;
#define SETBIT(j) do { const int j_ = (j); const unsigned bt_ = 1u << (j_ & 31); if (j_ < 32) m0 |= bt_; else if (j_ < 64) m1 |= bt_; else if (j_ < 96) m2 |= bt_; else m3 |= bt_; } while (0)
#define GETBIT(j) ((((j) < 32 ? m0 : (j) < 64 ? m1 : (j) < 96 ? m2 : m3) >> ((j) & 31)) & 1u)
    if (cur >= 1) { SETBIT(cur); ++nsel; }
    if (cur >= 2) { SETBIT(cur - 1); ++nsel; }
    for (; nsel < 16; ++nsel) {
        float best = -1.f; int bj = -1;
        for (int j = 1; j <= cur - 2; ++j) { if (GETBIT(j)) continue; const float v = imp[j * 64 + tid]; if (v > best) { best = v; bj = j; } }
        if (bj < 0) break;
        SETBIT(bj);
    }
    *(u32x4*)((unsigned*)(P.ws + WS_SEL) + ((size_t)(b * 2 + g) * S + t) * 4) = (u32x4){m0, m1, m2, m3};
}
__global__ void __launch_bounds__(64) k_slc_naive(Ptrs P) {
    const int t = blockIdx.x * 64 + threadIdx.x, h = blockIdx.y, b = blockIdx.z, g = h >> 2;
    const bf16_t* Kp = (const bf16_t*)(P.ws + WS_KV6) + (size_t)((2 * 2 + b) * 2 + g) * S * 64;
    const bf16_t* Vp = (const bf16_t*)(P.ws + WS_KV6) + (size_t)((3 * 2 + b) * 2 + g) * S * 64;
    const u32x4 mk = *(const u32x4*)((const unsigned*)(P.ws + WS_SEL) + ((size_t)(b * 2 + g) * S + t) * 4);
    const unsigned m0 = mk.x, m1 = mk.y, m2 = mk.z, m3 = mk.w;
    float q[64], o[64]; load_row64((const bf16_t*)(P.ws + WS_QN) + ((size_t)(b * 8 + h) * S + t) * 64, q);
#pragma unroll
    for (int d = 0; d < 64; ++d) o[d] = 0.f;
    Soft st{-1e30f, 0.f}; const float sl = nsa_slope2(h); const int cur = t >> 6;
    for (int j = cur; j >= 0; --j) { if (!GETBIT(j)) continue;
        for (int kk = 63; kk >= 0; --kk) { const int pos = 64 * j + kk; if (pos > t) continue;
            ONLINE_STEP(dot_row64(Kp + (size_t)pos * 64, q) - sl * (float)(t - pos), Vp + (size_t)pos * 64); } }
    const size_t row = (size_t)b * S + t; const float* G = (const float*)(P.ws + WS_GATE) + row * 24;
    const float g0 = G[h], g1 = G[8 + h], g2 = G[16 + h], il = 1.0f / st.l;
    const float* oc = (const float*)(P.ws + WS_OC) + row * 512 + h * 64;
    const bf16_t* ow = (const bf16_t*)(P.ws + WS_OW) + row * 512 + h * 64; const bf16_t* zn = (const bf16_t*)(P.ws + WS_ZN) + row * 512 + h * 64;
#pragma unroll
    for (int d = 0; d < 64; ++d) o[d] = (g0 * oc[d] + g1 * o[d] * il + g2 * bf2f(ow[d])) * bf2f(zn[d]);
    store_row64_bf16((bf16_t*)(P.ws + WS_ACAT) + row * 512 + h * 64, o, 1.0f);
}
__global__ void __launch_bounds__(256) k_final_norm(Ptrs P) {
    const int lane = threadIdx.x & 63, row = blockIdx.x * 4 + (threadIdx.x >> 6);
    f32x4* xr = (f32x4*)(P.out + (size_t)row * DM) + lane; const f32x4* gr = (const f32x4*)P.final_g + lane;
    f32x4 v[4]; float ss = 0.f;
#pragma unroll
    for (int j = 0; j < 4; ++j) { v[j] = xr[64 * j]; ss += (v[j].x * v[j].x + v[j].y * v[j].y) + (v[j].z * v[j].z + v[j].w * v[j].w); }
    const float rs = 1.0f / sqrtf(wave_sum(ss) * (1.f / DM) + RMS_EPS);
#pragma unroll
    for (int j = 0; j < 4; ++j) { const f32x4 g = gr[64 * j]; xr[64 * j] = (f32x4){v[j].x * rs * g.x, v[j].y * rs * g.y, v[j].z * rs * g.z, v[j].w * rs * g.w}; }
}

extern "C" void kernel_launch(void* const* d_in, const int* in_sizes, int n_in, void* d_out, int out_size, void* d_ws, size_t ws_size, hipStream_t stream) {
    if (n_in != 13 || out_size != M * DM || ws_size < WS_END) { fprintf(stderr, "kernel_launch: unexpected shapes (n_in %d out %d ws %zu)\n", n_in, out_size, ws_size); return; }
    Ptrs P{};
    P.x = (const float*)d_in[0]; P.norm_g = (const float*)d_in[1]; P.w_in = (const float*)d_in[2]; P.pos_k = (const float*)d_in[3]; P.w1_k = (const float*)d_in[4];
    P.w2_k = (const float*)d_in[5]; P.pos_v = (const float*)d_in[6]; P.w1_v = (const float*)d_in[7]; P.w2_v = (const float*)d_in[8]; P.w_brn = (const float*)d_in[9];
    P.w_brd = (const float*)d_in[10]; P.w_out = (const float*)d_in[11]; P.final_g = (const float*)d_in[12]; P.out = (float*)d_out; P.ws = (unsigned char*)d_ws;
    unsigned char* ws = P.ws; bf16_t* MG = (bf16_t*)d_out;
    hipLaunchKernelGGL(k_prep, dim3(1024), dim3(256), 0, stream, P);
    { EpiInProj E{ws, MG}; hipLaunchKernelGGL(k_gemm_simple<EpiInProj>, dim3((M / 128) * (NC / 64)), dim3(256), 0, stream, (const bf16_t*)(ws + WS_XN), (const bf16_t*)(ws + WS_WTIN), DM, NC / 64, E); }
    hipLaunchKernelGGL(k_compress_naive, dim3(8 * 512), dim3(64), 0, stream, P);
    hipLaunchKernelGGL(k_win_naive, dim3(S / 64, 8, NB), dim3(64), 0, stream, P);
    hipLaunchKernelGGL(k_dil_naive, dim3(S / 64, 24, NB), dim3(64), 0, stream, P);
    hipLaunchKernelGGL(k_cmp_naive, dim3(S / 64, 2, NB), dim3(64), 0, stream, P);
    hipLaunchKernelGGL(k_slc_naive, dim3(S / 64, 8, NB), dim3(64), 0, stream, P);
    hipLaunchKernelGGL(k_dil_combine, dim3(M * 64 / 256), dim3(256), 0, stream, P);
    { EpiBranch E{MG, (float*)(ws + WS_T1S), (bf16_t*)(ws + WS_MERGED), 0, 0};
      hipLaunchKernelGGL(k_gemm_simple<EpiBranch>, dim3((M / 128) * (1024 / 64)), dim3(256), 0, stream, (const bf16_t*)(ws + WS_ACAT), (const bf16_t*)(ws + WS_WTBR), 512, 1024 / 64, E);
      E.which = 1;
      hipLaunchKernelGGL(k_gemm_simple<EpiBranch>, dim3((M / 128) * (1024 / 64)), dim3(256), 0, stream, (const bf16_t*)(ws + WS_ACAT) + (size_t)M * 512, (const bf16_t*)(ws + WS_WTBR) + 1024 * 512, 512, 1024 / 64, E); }
    { EpiResid E{P.x, P.out}; hipLaunchKernelGGL(k_gemm_simple<EpiResid>, dim3((M / 128) * (1024 / 64)), dim3(256), 0, stream, (const bf16_t*)(ws + WS_MERGED), (const bf16_t*)(ws + WS_WTOUT), 1024, 1024 / 64, E); }
    hipLaunchKernelGGL(k_final_norm, dim3(M / 4), dim3(256), 0, stream, P);
}
```
